# Optimizing an MI355X kernel written in HIP

```python
import jax, jax.numpy as jnp
from jax import lax
import numpy as np

D_MODEL = 1024
BATCH = 2
SEQ = 8192
DEPTH = 2
DEC_BATCH = 128
DEC_SEQ = 4
PAST_LEN = 8192
PAGE_SIZE = 128

N_A = DEPTH // 2
N_B = DEPTH - N_A
N_META = 16
D_FF = 2816
CONV_W = 3
HEAD_DIM = 64
N_HEADS = D_MODEL // HEAD_DIM
N_KV = 4
GROUP = N_HEADS // N_KV
WINDOW = 128
BLOCK = WINDOW
ROPE_THETA = 10000.0
EPS = 1e-6
NEG = -1e30

kernel_name = "yoco_shortconv_swa_sink_decoder_step"


def rmsnorm(x, g):
    x32 = x.astype(jnp.float32)
    y = x32 * lax.rsqrt(jnp.mean(x32 * x32, axis=-1, keepdims=True) + EPS) * g.astype(jnp.float32)
    return y.astype(x.dtype)


def swiglu(h, w_in, w_out):
    gate, up = jnp.split(h @ w_in, 2, axis=-1)
    return (jax.nn.silu(gate) * up) @ w_out


def short_conv_mixer(h, prev_u, w_in, kern, w_out):
    T = h.shape[1]
    b, c, z = jnp.split(h @ w_in, 3, axis=-1)
    u = c * z
    u_full = jnp.concatenate([prev_u.astype(u.dtype), u], axis=1)
    conv = kern[0] * u_full[:, 0:T]
    for j in range(1, CONV_W):
        conv = conv + kern[j] * u_full[:, j:j + T]
    y = (b * conv) @ w_out
    return y, u_full[:, -(CONV_W - 1):]


def rope(x, pos):
    inv = 1.0 / (ROPE_THETA ** (jnp.arange(0, HEAD_DIM, 2, dtype=jnp.float32) / HEAD_DIM))
    ang = pos.astype(jnp.float32)[:, None] * inv[None, :]
    cos = jnp.cos(ang)[None, :, None, :]
    sin = jnp.sin(ang)[None, :, None, :]
    x32 = x.astype(jnp.float32)
    x1, x2 = jnp.split(x32, 2, axis=-1)
    out = jnp.concatenate([x1 * cos - x2 * sin, x2 * cos + x1 * sin], axis=-1)
    return out.astype(x.dtype)


def shared_kv(x, pos, g, w_kv):
    B, T, _ = x.shape
    k, v = jnp.split(rmsnorm(x, g) @ w_kv, 2, axis=-1)
    k = rope(k.reshape(B, T, N_KV, HEAD_DIM), pos)
    return k, v.reshape(B, T, N_KV, HEAD_DIM)


def query(h, w_q, pos):
    B, T, _ = h.shape
    return rope((h @ w_q).reshape(B, T, N_HEADS, HEAD_DIM), pos)


def sink_softmax(scores, mask, sinks):
    s = jnp.where(mask, scores, NEG)
    sk = sinks.astype(jnp.float32).reshape(N_KV, GROUP)[:, :, None, None]
    m = jnp.maximum(jnp.max(s, axis=-1, keepdims=True), sk)
    p = jnp.exp(s - m)
    denom = jnp.sum(p, axis=-1, keepdims=True) + jnp.exp(sk - m)
    return p / denom


def window_attn_prompt(q, k, v, sinks):
    B, L = q.shape[0], q.shape[1]
    P = (-L) % BLOCK
    Lp = L + P
    NB = Lp // BLOCK
    padw = ((0, 0), (P, 0), (0, 0), (0, 0))
    qb = jnp.pad(q, padw).reshape(B, NB, BLOCK, N_KV, GROUP, HEAD_DIM)
    kb = jnp.pad(k, padw).reshape(B, NB, BLOCK, N_KV, HEAD_DIM)
    vb = jnp.pad(v, padw).reshape(B, NB, BLOCK, N_KV, HEAD_DIM)
    kband = jnp.concatenate([jnp.concatenate([jnp.zeros_like(kb[:, :1]), kb[:, :-1]], axis=1), kb], axis=2)
    vband = jnp.concatenate([jnp.concatenate([jnp.zeros_like(vb[:, :1]), vb[:, :-1]], axis=1), vb], axis=2)
    blk = jnp.arange(NB, dtype=jnp.int32)[:, None]
    qpos = blk * BLOCK + jnp.arange(BLOCK, dtype=jnp.int32)[None, :] - P
    kpos = (blk - 1) * BLOCK + jnp.arange(2 * BLOCK, dtype=jnp.int32)[None, :] - P
    dist = qpos[:, :, None] - kpos[:, None, :]
    mask = (kpos[:, None, :] >= 0) & (dist >= 0) & (dist <= WINDOW)
    scores = jnp.einsum('bnqkgd,bnskd->bnkgqs', qb, kband).astype(jnp.float32) * (HEAD_DIM ** -0.5)
    p = sink_softmax(scores, mask[None, :, None, None], sinks)
    out = jnp.einsum('bnkgqs,bnskd->bnqkgd', p.astype(v.dtype), vband)
    return out.reshape(B, Lp, N_HEADS * HEAD_DIM)[:, P:]


def window_attn_sample(q, k_all, v_all, qpos, kpos, sinks):
    B, T = q.shape[0], q.shape[1]
    qg = q.reshape(B, T, N_KV, GROUP, HEAD_DIM)
    dist = qpos[:, None] - kpos[None, :]
    mask = (kpos[None, :] >= 0) & (dist >= 0) & (dist <= WINDOW)
    scores = jnp.einsum('btkgd,bskd->bkgts', qg, k_all).astype(jnp.float32) * (HEAD_DIM ** -0.5)
    p = sink_softmax(scores, mask, sinks)
    out = jnp.einsum('bkgts,bskd->btkgd', p.astype(v_all.dtype), v_all)
    return out.reshape(B, T, N_HEADS * HEAD_DIM)


def setup_inputs(seed: int = 0) -> dict:
    key = jax.random.key(seed)
    ks = jax.random.split(key, 20)
    f32 = jnp.float32
    w_keep = min(WINDOW, PAST_LEN)
    nrm = lambda k, shape, s: jax.random.normal(k, shape, f32) * s
    return {
        "x_prompt": nrm(ks[0], (BATCH, SEQ, D_MODEL), 1.0),
        "x_sample": nrm(ks[1], (DEC_BATCH, DEC_SEQ, D_MODEL), 1.0),
        "state_conv": nrm(ks[2], (N_A, DEC_BATCH, CONV_W - 1, D_MODEL), 1.0),
        "cache_k": nrm(ks[3], (DEC_BATCH, w_keep, N_KV, HEAD_DIM), 1.0),
        "cache_v": nrm(ks[4], (DEC_BATCH, w_keep, N_KV, HEAD_DIM), 1.0),
        "meta_tokens": nrm(ks[5], (N_META, D_MODEL), 1.0),
        "norm_g": 1.0 + nrm(ks[6], (DEPTH, 3, D_MODEL), 0.02),
        "ffn_w_in": nrm(ks[7], (DEPTH, 2, D_MODEL, 2 * D_FF), D_MODEL ** -0.5),
        "ffn_w_out": nrm(ks[8], (DEPTH, 2, D_FF, D_MODEL), D_FF ** -0.5),
        "conv_w_in": nrm(ks[9], (N_A, D_MODEL, 3 * D_MODEL), D_MODEL ** -0.5),
        "conv_kernel": nrm(ks[10], (N_A, CONV_W, D_MODEL), CONV_W ** -0.5),
        "conv_w_out": nrm(ks[11], (N_A, D_MODEL, D_MODEL), D_MODEL ** -0.5),
        "kv_norm_g": 1.0 + nrm(ks[12], (D_MODEL,), 0.02),
        "w_kv": nrm(ks[13], (D_MODEL, 2 * N_KV * HEAD_DIM), D_MODEL ** -0.5),
        "w_q": nrm(ks[14], (N_B, D_MODEL, N_HEADS * HEAD_DIM), D_MODEL ** -0.5),
        "w_o": nrm(ks[15], (N_B, N_HEADS * HEAD_DIM, D_MODEL), (N_HEADS * HEAD_DIM) ** -0.5),
        "sinks": nrm(ks[16], (N_B, N_HEADS), 0.5),
        "final_norm_g": 1.0 + nrm(ks[17], (D_MODEL,), 0.02),
    }


def reference(x_prompt, x_sample, state_conv, cache_k, cache_v, meta_tokens, norm_g,
              ffn_w_in, ffn_w_out, conv_w_in, conv_kernel, conv_w_out, kv_norm_g, w_kv,
              w_q, w_o, sinks, final_norm_g):
    B, Bd = x_prompt.shape[0], x_sample.shape[0]
    L = x_prompt.shape[1] + N_META
    T = x_sample.shape[1]
    w_keep_s = cache_k.shape[1]
    w_keep_p = min(WINDOW, L)

    meta = jnp.broadcast_to(meta_tokens[None].astype(x_prompt.dtype), (B, N_META, D_MODEL))
    xp = jnp.concatenate([meta, x_prompt], axis=1)
    xs = x_sample
    pos_p = jnp.arange(L, dtype=jnp.int32)
    pos_s = PAST_LEN + jnp.arange(T, dtype=jnp.int32)
    kpos_s = jnp.concatenate([PAST_LEN - w_keep_s + jnp.arange(w_keep_s, dtype=jnp.int32), pos_s])

    conv_p, conv_s = [], []
    for layer in range(DEPTH):
        if layer == N_A:
            kp, vp = shared_kv(xp, pos_p, kv_norm_g, w_kv)
            ks_new, vs_new = shared_kv(xs, pos_s, kv_norm_g, w_kv)
            ks_all = jnp.concatenate([cache_k.astype(ks_new.dtype), ks_new], axis=1)
            vs_all = jnp.concatenate([cache_v.astype(vs_new.dtype), vs_new], axis=1)
            new_k_p, new_v_p = kp[:, L - w_keep_p:], vp[:, L - w_keep_p:]
            new_k_s, new_v_s = ks_all[:, -w_keep_s:], vs_all[:, -w_keep_s:]
        g = norm_g[layer]
        xp = xp + 0.5 * swiglu(rmsnorm(xp, g[0]), ffn_w_in[layer, 0], ffn_w_out[layer, 0])
        xs = xs + 0.5 * swiglu(rmsnorm(xs, g[0]), ffn_w_in[layer, 0], ffn_w_out[layer, 0])
        hp, hs = rmsnorm(xp, g[1]), rmsnorm(xs, g[1])
        if layer < N_A:
            a = layer
            zero_prev = jnp.zeros((B, CONV_W - 1, D_MODEL), hp.dtype)
            yp, sp = short_conv_mixer(hp, zero_prev, conv_w_in[a], conv_kernel[a], conv_w_out[a])
            ys, ss = short_conv_mixer(hs, state_conv[a], conv_w_in[a], conv_kernel[a], conv_w_out[a])
            conv_p.append(sp)
            conv_s.append(ss)
        else:
            bi = layer - N_A
            qp = query(hp, w_q[bi], pos_p)
            yp = window_attn_prompt(qp, kp, vp, sinks[bi]) @ w_o[bi]
            qs = query(hs, w_q[bi], pos_s)
            ys = window_attn_sample(qs, ks_all, vs_all, pos_s, kpos_s, sinks[bi]) @ w_o[bi]
        xp = xp + yp
        xs = xs + ys
        xp = xp + 0.5 * swiglu(rmsnorm(xp, g[2]), ffn_w_in[layer, 1], ffn_w_out[layer, 1])
        xs = xs + 0.5 * swiglu(rmsnorm(xs, g[2]), ffn_w_in[layer, 1], ffn_w_out[layer, 1])

    y_prompt = rmsnorm(xp, final_norm_g)[:, N_META:]
    y_sample = rmsnorm(xs, final_norm_g)
    new_state_conv_p = jnp.stack(conv_p, axis=0)
    new_state_conv_s = jnp.stack(conv_s, axis=0)
    return (y_prompt, y_sample, new_state_conv_p, new_state_conv_s, new_k_p, new_v_p, new_k_s, new_v_s)
```

```cpp
#include <hip/hip_runtime.h>
#include <hip/hip_cooperative_groups.h>
#include <cstdio>
#include <cstdint>
namespace cg = cooperative_groups;
namespace pg8 {
#define PG8_LAS __attribute__((address_space(3)))
typedef unsigned short bf16_t;
typedef short bf16x8 __attribute__((ext_vector_type(8)));
typedef float f32x4 __attribute__((ext_vector_type(4)));
typedef unsigned u32x4 __attribute__((ext_vector_type(4)));
constexpr int BM = 256, BK = 64, HALF = 128, HTB = HALF * BK * 2  , STAGE_BYTES = 8 * HTB, NXCD = 8, WGM = 8;

__host__ __device__ __forceinline__ int lds_byte(int r, int c) { const int st = (r >> 4) * 2 + (c >> 5), rr = r & 15, cc = c & 31, ob = rr * 64 + cc * 2; return st * 1024 + (ob ^ (((ob >> 9) & 1) << 5)); }
__host__ __device__ __forceinline__ void stage_rc(int b, int& R, int& C) { const int st = b / 1024, sb = b % 1024, swz = sb ^ (((sb >> 9) & 1) << 5); R = (st >> 1) * 16 + swz / 64; C = (st & 1) * 32 + (swz % 64) / 2; }
__host__ __device__ __forceinline__ int perm32(int rho) { const int n = rho >> 4, i = rho & 15; return 8 * (i >> 2) + 4 * n + (i & 3); }

struct Unit { int pm, pn; };
struct Gemm { const bf16_t* A; const bf16_t* Bt; int M, N, K; };

struct StaticOrder {
    int nM, nN, nwg, G, c;
    __host__ __device__ void init(int M, int N, int G_, int c_) { nM = M / BM; nN = N / BM; nwg = nM * nN; G = G_; c = c_; }
    __host__ __device__ bool next(int i, Unit& u) const {
        const long L = (long)i * G + c; if (L >= nwg) return false;
        int wgid = (int)L; { const int q = nwg / NXCD, r = nwg % NXCD, xcd = wgid % NXCD, off = wgid / NXCD; wgid = (xcd < r ? xcd * (q + 1) : r * (q + 1) + (xcd - r) * q) + off; }
        const int nig = WGM * nN, gid = wgid / nig, fm = gid * WGM, gsz = (nM - fm) < WGM ? (nM - fm) : WGM;
        u.pm = fm + ((wgid % nig) % gsz); u.pn = (wgid % nig) / gsz; return true;
    }
    __device__ __forceinline__ void a_ready(const Unit&) const {}
    __device__ __forceinline__ void done(const Unit&) const {}
};

__device__ __forceinline__ unsigned cvt_pk_bf16(float lo, float hi) { unsigned r; asm volatile("v_cvt_pk_bf16_f32 %0, %1, %2" : "=v"(r) : "v"(lo), "v"(hi)); return r; }
typedef float f32x2 __attribute__((ext_vector_type(2)));
__device__ __forceinline__ f32x2 gelu_pk(f32x2 v) {
    const f32x2 av = __builtin_elementwise_abs(v), d = av * 0.2316418882f + 1.0f;
    f32x2 t; t.x = __builtin_amdgcn_rcpf(d.x); t.y = __builtin_amdgcn_rcpf(d.y);
    f32x2 q = t * 0.5307027145f + (-0.7265760135f); q = q * t + 0.7107068705f; q = q * t + (-0.142248368f); q = q * t + 0.127414796f; q = q * t;
    const f32x2 s = (v * v) * (-0.72134752044f);
    f32x2 e; e.x = __builtin_amdgcn_exp2f(s.x); e.y = __builtin_amdgcn_exp2f(s.y);
    const f32x2 m = v * (q * e), r = v - m;
    f32x2 o; o.x = v.x < 0.f ? m.x : r.x; o.y = v.y < 0.f ? m.y : r.y; return o;
}

template <int ACT  > struct EpiBf16 {
    static constexpr bool PERM = true, AFTER_DRAIN = false; static_assert(ACT == 0 || ACT == 1, "EpiBf16: ACT is 0 (none) or 1 (gelu_pk)");
    bf16_t* O; int ldc; const float* bias; int split_cols; size_t split_stride; float scale0;
    __device__ __forceinline__ void operator()(const f32x4 (&acc)[2][2][4][2], const Unit& u, int wr, int wc, int fr, int fq) const {
        const int row0 = u.pm * BM + wr * 64 + fr; int colt = u.pn * BM; bf16_t* base = O;
        float sc = 1.f; if (split_cols) { const int t = colt / split_cols; base += (size_t)t * split_stride; colt -= t * split_cols; if (t == 0) sc = scale0; }
        const int col0 = colt + wc * 32 + 8 * fq, bcol0 = u.pn * BM + wc * 32 + 8 * fq;
        f32x4 bv[2][2];
#pragma unroll
        for (int bj = 0; bj < 2; ++bj)
#pragma unroll
            for (int n = 0; n < 2; ++n) bv[bj][n] = bias ? *(const f32x4*)(bias + bcol0 + bj * HALF + 4 * n) : (f32x4){0.f, 0.f, 0.f, 0.f};
#pragma unroll
        for (int ai = 0; ai < 2; ++ai)
#pragma unroll
            for (int m = 0; m < 4; ++m) { bf16_t* rowp = base + (size_t)(row0 + ai * HALF + m * 16) * ldc + col0;
#pragma unroll
                for (int bj = 0; bj < 2; ++bj) { f32x4 v0 = acc[ai][bj][m][0] + bv[bj][0], v1 = acc[ai][bj][m][1] + bv[bj][1];
                    if (ACT == 1) { f32x2 a = gelu_pk((f32x2){v0[0], v0[1]}), b = gelu_pk((f32x2){v0[2], v0[3]}), c = gelu_pk((f32x2){v1[0], v1[1]}), d = gelu_pk((f32x2){v1[2], v1[3]});
                        v0 = (f32x4){a.x, a.y, b.x, b.y}; v1 = (f32x4){c.x, c.y, d.x, d.y}; }
                    v0 = v0 * sc; v1 = v1 * sc; u32x4 w; w.x = cvt_pk_bf16(v0[0], v0[1]); w.y = cvt_pk_bf16(v0[2], v0[3]); w.z = cvt_pk_bf16(v1[0], v1[1]); w.w = cvt_pk_bf16(v1[2], v1[3]);
                    *(u32x4*)(rowp + bj * HALF) = w; } }
    }
};
template <class Epi, class Sched, bool ALIGN_EPI = false, bool SP2 = false>
__device__ __forceinline__ void gemm_phase(PG8_LAS unsigned char* lds, const Gemm g, const Sched& S, const Epi& E) {
    int tid_ = threadIdx.x; asm volatile("" : "+v"(tid_));
    const int tid = tid_, wid = __builtin_amdgcn_readfirstlane(tid >> 6), lane = tid & 63, wr = wid >> 2, wc = wid & 3, fr = lane & 15, fq = lane >> 4;
    const int K = g.K, nt = K / BK;
    unsigned voffA[2], voffB[2];
#pragma unroll
    for (int i = 0; i < 2; ++i) { int R, C; stage_rc(tid * 16 + i * 8192, R, C); const int Rb = E.perm ? ((R & ~31) + perm32(R & 31)) : R;
        voffA[i] = (unsigned)(R * K + C) * 2u; voffB[i] = (unsigned)(Rb * K + C) * 2u; }
    const size_t kstep = (size_t)(BK * 2);
    const size_t hstep = (size_t)HALF * K * 2;
    const size_t tstep = 2 * hstep;
    const unsigned ldsw = (unsigned)wid * 1024u;
    const int aoff = lds_byte(wr * 64 + fr, fq * 8), boff = lds_byte(wc * 32 + fr, fq * 8);
#define PG8_SA(b, h) (((b) * 2 + (h)) * HTB)
#define PG8_SB(b, h) ((4 + (b) * 2 + (h)) * HTB)
#define PG8_STAGE(bufoff, gbase, voff) do { _Pragma("unroll") for (int _i = 0; _i < 2; ++_i) \
        __builtin_amdgcn_global_load_lds((const unsigned*)((const char*)(gbase) + (voff)[_i]), (PG8_LAS unsigned*)(lds + (bufoff) + ldsw + _i * 8192), 16, 0, 0); } while (0)
#define PG8_LDA(dst, b, h) do { _Pragma("unroll") for (int m = 0; m < 4; ++m) _Pragma("unroll") for (int k = 0; k < 2; ++k) dst[m][k] = *(const PG8_LAS bf16x8*)(lds + PG8_SA(b, h) + aoff + m * 2048 + k * 1024); } while (0)
#define PG8_LDB(dst, b, h) do { _Pragma("unroll") for (int n = 0; n < 2; ++n) _Pragma("unroll") for (int k = 0; k < 2; ++k) dst[n][k] = *(const PG8_LAS bf16x8*)(lds + PG8_SB(b, h) + boff + n * 2048 + k * 1024); } while (0)
#define PG8_MMA(ai, bj, At, Bt) do { __builtin_amdgcn_s_setprio(1); _Pragma("unroll") for (int m = 0; m < 4; ++m) _Pragma("unroll") for (int n = 0; n < 2; ++n) _Pragma("unroll") for (int k = 0; k < 2; ++k) \
        acc[ai][bj][m][n] = __builtin_amdgcn_mfma_f32_16x16x32_bf16(Bt[n][k], At[m][k], acc[ai][bj][m][n], 0, 0, 0); __builtin_amdgcn_s_setprio(0); } while (0)
#define PG8_WAIT_V(n) asm volatile("s_waitcnt vmcnt(" #n ")" ::: "memory")
#define PG8_WAIT_L(n) asm volatile("s_waitcnt lgkmcnt(" #n ")" ::: "memory")
#define PG8_BAR __builtin_amdgcn_s_barrier()
#define PG8_SCHED __builtin_amdgcn_sched_barrier(0)
    Unit cur, nxt; int ui = 0;
    if (!S.next(0, cur)) return;
    f32x4 acc[2][2][4][2];
#pragma unroll
    for (int a = 0; a < 2; ++a)
#pragma unroll
        for (int b = 0; b < 2; ++b)
#pragma unroll
            for (int m = 0; m < 4; ++m)
#pragma unroll
                for (int n = 0; n < 2; ++n) acc[a][b][m][n] = (f32x4){0.f, 0.f, 0.f, 0.f};
    bf16x8 At[4][2], B0[2][2], B1[2][2];
    const char* cA = (const char*)g.A + (size_t)cur.pm * tstep; const char* cB = (const char*)g.Bt + (size_t)cur.pn * tstep;
    S.a_ready(cur);
    if constexpr (SP2) {
        PG8_STAGE(PG8_SB(0, 0), cB, voffB); PG8_STAGE(PG8_SB(0, 1), cB + hstep, voffB); PG8_STAGE(PG8_SA(0, 0), cA, voffA); PG8_STAGE(PG8_SA(0, 1), cA + hstep, voffA);
        if (wr == 1) PG8_BAR;
        PG8_WAIT_V(2); PG8_BAR;
        PG8_STAGE(PG8_SB(1, 0), cB + kstep, voffB); PG8_STAGE(PG8_SA(1, 0), cA + kstep, voffA); PG8_STAGE(PG8_SB(1, 1), cB + hstep + kstep, voffB);
        PG8_WAIT_V(6); PG8_BAR;
    } else {
        PG8_STAGE(PG8_SB(0, 0), cB, voffB); PG8_STAGE(PG8_SA(0, 0), cA, voffA); PG8_STAGE(PG8_SB(0, 1), cB + hstep, voffB); PG8_STAGE(PG8_SA(0, 1), cA + hstep, voffA);
        if (wr == 1) PG8_BAR;
        PG8_WAIT_V(4); PG8_BAR;
        PG8_STAGE(PG8_SB(1, 0), cB + kstep, voffB); PG8_STAGE(PG8_SA(1, 0), cA + kstep, voffA); PG8_STAGE(PG8_SB(1, 1), cB + hstep + kstep, voffB);
        PG8_WAIT_V(6); PG8_BAR;
    }
    for (;;) {
        const bool has_next = S.next(ui + 1, nxt);
        const char* nA = has_next ? (const char*)g.A + (size_t)nxt.pm * tstep : cA; const char* nB = has_next ? (const char*)g.Bt + (size_t)nxt.pn * tstep : cB;
        for (int t = 0; t < nt; t += 2) {
            const bool last = (t == nt - 2);
            const char* a1 = cA + (size_t)(t + 1) * kstep;
            const char* a2 = last ? nA : cA + (size_t)(t + 2) * kstep; const char* b2 = last ? nB : cB + (size_t)(t + 2) * kstep;
            const char* a3 = a2 + kstep; const char* b3 = b2 + kstep;
            if (last && has_next) S.a_ready(nxt);
            if constexpr (SP2) {
            PG8_LDB(B0, 0, 0); PG8_LDB(B1, 0, 1); PG8_SCHED; PG8_LDA(At, 0, 0); PG8_STAGE(PG8_SA(1, 1), a1 + hstep, voffA);
            PG8_WAIT_V(8); PG8_WAIT_L(0); PG8_BAR; PG8_MMA(0, 0, At, B0); PG8_MMA(0, 1, At, B1); PG8_BAR; PG8_SCHED;
            PG8_LDA(At, 0, 1); PG8_STAGE(PG8_SB(0, 0), b2, voffB); PG8_STAGE(PG8_SB(0, 1), b2 + hstep, voffB); PG8_STAGE(PG8_SA(0, 0), a2, voffA);
            PG8_WAIT_V(8); PG8_WAIT_L(0); PG8_BAR; PG8_MMA(1, 0, At, B0); PG8_MMA(1, 1, At, B1); PG8_BAR; PG8_SCHED;
            PG8_LDB(B0, 1, 0); PG8_LDB(B1, 1, 1); PG8_SCHED; PG8_LDA(At, 1, 0); PG8_STAGE(PG8_SA(0, 1), a2 + hstep, voffA);
            PG8_WAIT_V(8); PG8_WAIT_L(0); PG8_BAR; PG8_MMA(0, 0, At, B0); PG8_MMA(0, 1, At, B1); PG8_BAR; PG8_SCHED;
            PG8_LDA(At, 1, 1); PG8_STAGE(PG8_SB(1, 0), b3, voffB); PG8_STAGE(PG8_SB(1, 1), b3 + hstep, voffB); PG8_STAGE(PG8_SA(1, 0), a3, voffA);
            PG8_WAIT_V(8); PG8_WAIT_L(0); PG8_BAR; PG8_MMA(1, 0, At, B0); PG8_MMA(1, 1, At, B1); PG8_BAR; PG8_SCHED;
            } else {
            PG8_LDB(B0, 0, 0); PG8_SCHED; PG8_LDA(At, 0, 0); PG8_STAGE(PG8_SA(1, 1), a1 + hstep, voffA);
            PG8_WAIT_L(8); PG8_BAR; PG8_WAIT_L(0); PG8_MMA(0, 0, At, B0); PG8_BAR; PG8_SCHED;
            PG8_LDB(B1, 0, 1); PG8_STAGE(PG8_SB(0, 0), b2, voffB);
            PG8_BAR; PG8_WAIT_L(0); PG8_MMA(0, 1, At, B1); PG8_BAR;
            PG8_LDA(At, 0, 1); PG8_STAGE(PG8_SA(0, 0), a2, voffA);
            PG8_BAR; PG8_WAIT_L(0); PG8_MMA(1, 0, At, B0); PG8_BAR; PG8_SCHED;
            PG8_STAGE(PG8_SB(0, 1), b2 + hstep, voffB);
            PG8_WAIT_V(6); PG8_BAR; PG8_MMA(1, 1, At, B1); PG8_BAR;
            PG8_LDB(B0, 1, 0); PG8_SCHED; PG8_LDA(At, 1, 0); PG8_STAGE(PG8_SA(0, 1), a2 + hstep, voffA);
            PG8_WAIT_L(8); PG8_BAR; PG8_WAIT_L(0); PG8_MMA(0, 0, At, B0); PG8_BAR; PG8_SCHED;
            PG8_LDB(B1, 1, 1); PG8_STAGE(PG8_SB(1, 0), b3, voffB);
            PG8_BAR; PG8_WAIT_L(0); PG8_MMA(0, 1, At, B1); PG8_BAR;
            PG8_LDA(At, 1, 1); PG8_STAGE(PG8_SA(1, 0), a3, voffA);
            PG8_BAR; PG8_WAIT_L(0); PG8_MMA(1, 0, At, B0); PG8_BAR; PG8_SCHED;
            PG8_STAGE(PG8_SB(1, 1), b3 + hstep, voffB);
            PG8_WAIT_V(6); PG8_BAR; PG8_MMA(1, 1, At, B1); PG8_BAR;
            }
        }
        if constexpr (ALIGN_EPI) { if (wr == 0) PG8_BAR; }
        if constexpr (!Epi::AFTER_DRAIN) { E(acc, cur, wr, wc, fr, fq); S.done(cur); }
        if (!has_next) break;
#pragma unroll
        for (int a = 0; a < 2; ++a)
#pragma unroll
            for (int b = 0; b < 2; ++b)
#pragma unroll
                for (int m = 0; m < 4; ++m)
#pragma unroll
                    for (int n = 0; n < 2; ++n) acc[a][b][m][n] = (f32x4){0.f, 0.f, 0.f, 0.f};
        cur = nxt; cA = nA; cB = nB; ++ui;
        if constexpr (ALIGN_EPI) { if (wr == 1) PG8_BAR; }
    }
    PG8_WAIT_V(0);
    if constexpr (!ALIGN_EPI) { if (wr == 0) PG8_BAR; }
    PG8_BAR;
    if constexpr (Epi::AFTER_DRAIN) { E.fused(acc, cur, wr, wc, fr, fq, lds, wid, lane); S.done(cur); }
#undef PG8_SA
#undef PG8_SB
#undef PG8_STAGE
#undef PG8_LDA
#undef PG8_LDB
#undef PG8_MMA
#undef PG8_WAIT_V
#undef PG8_WAIT_L
#undef PG8_BAR
#undef PG8_SCHED
}
}

#ifndef PHASE_MASK
#define PHASE_MASK 0xFFFF
#endif
#define EN(t) (((PHASE_MASK) >> (t)) & 1)
#ifndef ONE_LAUNCH
#define ONE_LAUNCH 0
#endif
#define LAS __attribute__((address_space(3)))
typedef unsigned short bf16;
typedef unsigned u32x4 __attribute__((ext_vector_type(4)));
typedef unsigned u32x2 __attribute__((ext_vector_type(2)));
typedef float f32x4 __attribute__((ext_vector_type(4)));
typedef float f32x16 __attribute__((ext_vector_type(16)));
typedef short bf16x8 __attribute__((ext_vector_type(8)));
typedef float f32x2_t __attribute__((ext_vector_type(2)));
typedef __bf16 bf16x2_t __attribute__((ext_vector_type(2)));

constexpr int D = 1024, FF = 2816, LP = 8208, NPR = 2 * LP, NSR = 512, MR = NPR + NSR, MP = 17152;
constexpr int NWAVES = 8, NTHREADS = 512;
constexpr size_t align_mb(size_t x) { return (x + 0xFFFFF) & ~(size_t)0xFFFFF; }
constexpr size_t SZ_FFIN = (size_t)2 * FF * D * 2, SZ_FFOUT = (size_t)D * FF * 2;
constexpr size_t WS_FFIN = 0;
constexpr size_t WS_FFOUT = WS_FFIN + 4 * SZ_FFIN;
constexpr size_t WS_CIN = WS_FFOUT + 4 * SZ_FFOUT;
constexpr size_t WS_COUT = WS_CIN + (size_t)3 * D * D * 2;
constexpr size_t WS_KVW = WS_COUT + (size_t)D * D * 2;
constexpr size_t WS_QW = WS_KVW + (size_t)512 * D * 2;
constexpr size_t WS_OW = WS_QW + (size_t)D * D * 2;
constexpr size_t WS_TAB = WS_OW + (size_t)D * D * 2;
constexpr size_t WS_X = align_mb(WS_TAB + (size_t)LP * 32 * 8);
constexpr size_t WS_H = WS_X + (size_t)MP * D * 4;
constexpr size_t WS_K = WS_H + (size_t)MP * D * 2;
constexpr size_t WS_V = WS_K + (size_t)MP * 256 * 2;
constexpr size_t WS_ACT = WS_V + (size_t)MP * 256 * 2;
constexpr size_t WS_END = WS_ACT + (size_t)MP * FF * 2;
constexpr size_t WS_BC = WS_ACT, WS_U = WS_ACT + (size_t)MP * D * 2;
constexpr size_t WS_Q = WS_ACT, WS_O = WS_ACT + (size_t)MP * D * 2;

constexpr long OY_P = 0, OY_S = 16777216, OCONV_P = 17301504, OCONV_S = 17305600, OK_P = 17567744, OV_P = 17633280, OK_S = 17698816, OV_S = 21893120, OUT_TOTAL = 26087424;
constexpr float LOG2E = 1.4426950408889634f;
constexpr float QSCALE = 0.125f * LOG2E;
constexpr int LDS_BYTES = 147456;

__constant__ double c_rope_inv[32] = {
1.0, 0.7498942093324559, 0.5623413251903491, 0.4216965034285822,
0.31622776601683794, 0.23713737056616552, 0.1778279410038923, 0.1333521432163324,
0.1, 0.07498942093324558, 0.05623413251903491, 0.042169650342858224,
0.03162277660168379, 0.023713737056616554, 0.01778279410038923, 0.01333521432163324,
0.01, 0.007498942093324558, 0.005623413251903491, 0.004216965034285823,
0.0031622776601683794, 0.0023713737056616554, 0.0017782794100389228, 0.001333521432163324,
0.001, 0.0007498942093324559, 0.0005623413251903491, 0.00042169650342858224,
0.00031622776601683794, 0.00023713737056616554, 0.00017782794100389227, 0.0001333521432163324};

__device__ __forceinline__ unsigned cvtpk(float lo, float hi) { f32x2_t v = {lo, hi}; bf16x2_t b = __builtin_convertvector(v, bf16x2_t); return __builtin_bit_cast(unsigned, b); }
__device__ __forceinline__ float bf_lo(unsigned w) { return __uint_as_float(w << 16); }
__device__ __forceinline__ float bf_hi(unsigned w) { return __uint_as_float(w & 0xffff0000u); }
__device__ __forceinline__ int rowpos(int row) { return row < LP ? row : (row < NPR ? row - LP : (row < MR ? 8192 + ((row - NPR) & 3) : 0)); }
__device__ __forceinline__ long conv_out_off(int row) {
    if (row < NPR) { const int b = row >= LP ? 1 : 0; const int pos = row - b * LP; return pos >= LP - 2 ? OCONV_P + (long)(b * 2 + pos - (LP - 2)) * 1024 : -1; }
    if (row < MR) { const int r = row - NPR, t = r & 3; return t >= 2 ? OCONV_S + (long)((r >> 2) * 2 + t - 2) * 1024 : -1; }
    return -1;
}
__device__ __forceinline__ long kv_out_off(int row, long& vd) {
    if (row < NPR) { const int b = row >= LP ? 1 : 0; const int pos = row - b * LP; vd = OV_P - OK_P; return pos >= LP - 128 ? OK_P + (long)(b * 128 + pos - (LP - 128)) * 256 : -1; }
    if (row < MR) { const int r = row - NPR; vd = OV_S - OK_S; return OK_S + (long)((r >> 2) * 128 + 124 + (r & 3)) * 256; }
    vd = 0; return -1;
}
__device__ __forceinline__ float silu_mul(float g, float u) { return g * u * __builtin_amdgcn_rcpf(1.0f + __builtin_amdgcn_exp2f(-g * LOG2E)); }

namespace pg8 {
__device__ __forceinline__ void rope8(const f32x4 a0, const f32x4 a1, const f32x4 b0, const f32x4 b1, const float* trow, float s, f32x4& o10, f32x4& o11, f32x4& o20, f32x4& o21) {
    const f32x4 t0 = *(const f32x4*)(trow), t1 = *(const f32x4*)(trow + 4), t2 = *(const f32x4*)(trow + 8), t3 = *(const f32x4*)(trow + 12);
    const f32x4 c0 = {t0[0], t0[2], t1[0], t1[2]}, s0 = {t0[1], t0[3], t1[1], t1[3]};
    const f32x4 c1 = {t2[0], t2[2], t3[0], t3[2]}, s1 = {t2[1], t2[3], t3[1], t3[3]};
    o10 = (a0 * c0 - b0 * s0) * s; o11 = (a1 * c1 - b1 * s1) * s;
    o20 = (b0 * c0 + a0 * s0) * s; o21 = (b1 * c1 + a1 * s1) * s;
}
__device__ __forceinline__ u32x4 pack8(const f32x4 p0, const f32x4 p1) { u32x4 w; w.x = cvtpk(p0[0], p0[1]); w.y = cvtpk(p0[2], p0[3]); w.z = cvtpk(p1[0], p1[1]); w.w = cvtpk(p1[2], p1[3]); return w; }
enum { EK_SWIGLU = 0, EK_RESID, EK_CONVIN, EK_KV, EK_Q };
struct EpiMulti {
    static constexpr bool AFTER_DRAIN = false;
    int kind; bool perm;
    bf16_t* o0; bf16_t* o1; float* X; const float* tab; float scale;
    __device__ __forceinline__ void operator()(const f32x4 (&acc)[2][2][4][2], const Unit& u, int wr, int wc, int fr, int fq) const {
        const int row0 = u.pm * BM + wr * 64 + fr;
        if (kind == EK_SWIGLU) {
            const int col0 = u.pn * 128 + wc * 32 + 8 * fq;
#pragma unroll
            for (int ai = 0; ai < 2; ++ai)
#pragma unroll
                for (int m = 0; m < 4; ++m) {
                    bf16_t* rowp = o0 + (size_t)(row0 + ai * HALF + m * 16) * FF + col0;
                    const f32x4 g0 = acc[ai][0][m][0], g1 = acc[ai][0][m][1], u0 = acc[ai][1][m][0], u1 = acc[ai][1][m][1];
                    u32x4 w;
                    w.x = cvtpk(silu_mul(g0[0], u0[0]), silu_mul(g0[1], u0[1])); w.y = cvtpk(silu_mul(g0[2], u0[2]), silu_mul(g0[3], u0[3]));
                    w.z = cvtpk(silu_mul(g1[0], u1[0]), silu_mul(g1[1], u1[1])); w.w = cvtpk(silu_mul(g1[2], u1[2]), silu_mul(g1[3], u1[3]));
                    *(u32x4*)rowp = w;
                }
        } else if (kind == EK_RESID) {
            const int col0 = u.pn * BM + wc * 32 + 4 * fq;
#pragma unroll
            for (int ai = 0; ai < 2; ++ai)
#pragma unroll
                for (int m = 0; m < 4; ++m) {
                    float* rowp = X + (size_t)(row0 + ai * HALF + m * 16) * D + col0;
                    f32x4 x[2][2];
#pragma unroll
                    for (int bj = 0; bj < 2; ++bj)
#pragma unroll
                        for (int n = 0; n < 2; ++n) x[bj][n] = *(const f32x4*)(rowp + bj * HALF + n * 16);
#pragma unroll
                    for (int bj = 0; bj < 2; ++bj)
#pragma unroll
                        for (int n = 0; n < 2; ++n) *(f32x4*)(rowp + bj * HALF + n * 16) = x[bj][n] + acc[ai][bj][m][n] * scale;
                }
        } else if (kind == EK_CONVIN) {
            if (u.pn < 8) {
                const int ch0 = u.pn * 128 + wc * 32 + 8 * fq;
#pragma unroll
                for (int ai = 0; ai < 2; ++ai)
#pragma unroll
                    for (int m = 0; m < 4; ++m)
                        *(u32x4*)(o1 + (size_t)(row0 + ai * HALF + m * 16) * D + ch0) = pack8(acc[ai][0][m][0] * acc[ai][1][m][0], acc[ai][0][m][1] * acc[ai][1][m][1]);
            } else {
                const int c0 = (u.pn - 8) * 256 + wc * 32 + 8 * fq;
#pragma unroll
                for (int ai = 0; ai < 2; ++ai)
#pragma unroll
                    for (int m = 0; m < 4; ++m)
#pragma unroll
                        for (int bj = 0; bj < 2; ++bj)
                            *(u32x4*)(o0 + (size_t)(row0 + ai * HALF + m * 16) * D + c0 + bj * HALF) = pack8(acc[ai][bj][m][0], acc[ai][bj][m][1]);
            }
        } else if (kind == EK_KV && u.pn == 1) {
#pragma unroll
            for (int ai = 0; ai < 2; ++ai)
#pragma unroll
                for (int m = 0; m < 4; ++m)
#pragma unroll
                    for (int bj = 0; bj < 2; ++bj)
                        *(u32x4*)(o1 + (size_t)(row0 + ai * HALF + m * 16) * 256 + bj * HALF + wc * 32 + 8 * fq) = pack8(acc[ai][bj][m][0], acc[ai][bj][m][1]);
        } else {
            const int ld = kind == EK_KV ? 256 : D;
            const int c = (kind == EK_KV ? wc : u.pn * 4 + wc) * 64 + 8 * fq;
#pragma unroll
            for (int ai = 0; ai < 2; ++ai)
#pragma unroll
                for (int m = 0; m < 4; ++m) {
                    const int row = row0 + ai * HALF + m * 16;
                    f32x4 o10, o11, o20, o21;
                    rope8(acc[ai][0][m][0], acc[ai][0][m][1], acc[ai][1][m][0], acc[ai][1][m][1], tab + (size_t)rowpos(row) * 64 + 16 * fq, scale, o10, o11, o20, o21);
                    *(u32x4*)(o0 + (size_t)row * ld + c) = pack8(o10, o11);
                    *(u32x4*)(o0 + (size_t)row * ld + c + 32) = pack8(o20, o21);
                }
        }
    }
};
}

__device__ __forceinline__ float wave_sum(float v) {
#pragma unroll
    for (int o = 1; o < 64; o <<= 1) v += __shfl_xor(v, o);
    return v;
}
__device__ __forceinline__ void wt_item(const float* W, int Nsrc, int K, int src_c0, bf16* WTrow0, const float* g, int k0, LAS float* scr, int lane) {
#pragma unroll 8
    for (int i = 0; i < 32; ++i) { const int kk = 2 * i + (lane >> 5); float v = W[(size_t)(k0 + kk) * Nsrc + src_c0 + (lane & 31)]; if (g) v *= g[k0 + kk]; scr[kk * 33 + (lane & 31)] = v; }
    asm volatile("s_waitcnt lgkmcnt(0)" ::: "memory");
    const int c = lane & 7;
#pragma unroll
    for (int j = 0; j < 4; ++j) { const int n = (lane >> 3) + 8 * j; const LAS float* s = scr + (8 * c) * 33 + n;
        u32x4 o; o.x = cvtpk(s[0 * 33], s[1 * 33]); o.y = cvtpk(s[2 * 33], s[3 * 33]); o.z = cvtpk(s[4 * 33], s[5 * 33]); o.w = cvtpk(s[6 * 33], s[7 * 33]);
        *(u32x4*)(WTrow0 + (size_t)n * K + k0 + 8 * c) = o; }
    asm volatile("s_waitcnt lgkmcnt(0)" ::: "memory");
}
__device__ __forceinline__ void norm_row(const float* xrow, float* xstore, bf16* hrow, int lane) {
    f32x4 v[4]; float s = 0.f;
#pragma unroll
    for (int j = 0; j < 4; ++j) { v[j] = xrow ? *((const f32x4*)xrow + lane + 64 * j) : (f32x4){0.f, 0.f, 0.f, 0.f}; s += (v[j][0] * v[j][0] + v[j][1] * v[j][1]) + (v[j][2] * v[j][2] + v[j][3] * v[j][3]); }
    const float rstd = 1.0f / sqrtf(wave_sum(s) * (1.0f / D) + 1e-6f);
#pragma unroll
    for (int j = 0; j < 4; ++j) {
        if (xstore) *((f32x4*)xstore + lane + 64 * j) = v[j];
        u32x2 w; w.x = cvtpk(v[j][0] * rstd, v[j][1] * rstd); w.y = cvtpk(v[j][2] * rstd, v[j][3] * rstd);
        *((u32x2*)hrow + lane + 64 * j) = w;
    }
}

constexpr int KPITCH = 144, VPITCH = 400;
constexpr int ATT_KS = 0, ATT_VT = 192 * KPITCH;
__device__ __forceinline__ int crow(int r, int hi) { return (r & 3) + 8 * (r >> 2) + 4 * hi; }
__device__ __forceinline__ void attn_wave(const LAS unsigned char* Ks, const LAS unsigned char* Vt, const bf16* qptr, bf16* optr, bool qvalid, int qp, int kpos0, float sink2, int lane) {
    const int l31 = lane & 31, hi = lane >> 5;
    bf16x8 qf[4];
#pragma unroll
    for (int s = 0; s < 4; ++s) { u32x4 t = {0u, 0u, 0u, 0u}; if (qvalid) t = *(const u32x4*)(qptr + 16 * s + 8 * hi); qf[s] = __builtin_bit_cast(bf16x8, t); }
    f32x16 S[5];
#pragma unroll
    for (int kt = 0; kt < 5; ++kt) {
#pragma unroll
        for (int r = 0; r < 16; ++r) S[kt][r] = 0.f;
#pragma unroll
        for (int s = 0; s < 4; ++s) {
            const bf16x8 a = *(const LAS bf16x8*)(Ks + (32 * kt + l31) * KPITCH + 32 * s + 16 * hi);
            S[kt] = __builtin_amdgcn_mfma_f32_32x32x16_bf16(a, qf[s], S[kt], 0, 0, 0);
        }
    }
    float mx = sink2;
#pragma unroll
    for (int kt = 0; kt < 5; ++kt)
#pragma unroll
        for (int r = 0; r < 16; ++r) {
            const int kp = kpos0 + 32 * kt + crow(r, hi), dist = qp - kp;
            const bool ok = (kp >= 0) && (dist >= 0) && (dist <= 128);
            const float v = ok ? S[kt][r] : -1e30f;
            S[kt][r] = v; mx = fmaxf(mx, v);
        }
    mx = fmaxf(mx, __shfl_xor(mx, 32));
    float sum = 0.f;
#pragma unroll
    for (int kt = 0; kt < 5; ++kt)
#pragma unroll
        for (int r = 0; r < 16; ++r) { const float p = __builtin_amdgcn_exp2f(S[kt][r] - mx); S[kt][r] = p; sum += p; }
    sum += __shfl_xor(sum, 32);
    const float inv = 1.0f / (sum + __builtin_amdgcn_exp2f(sink2 - mx));
    f32x16 O[2];
#pragma unroll
    for (int dt = 0; dt < 2; ++dt)
#pragma unroll
        for (int r = 0; r < 16; ++r) O[dt][r] = 0.f;
#pragma unroll
    for (int kt = 0; kt < 5; ++kt)
#pragma unroll
        for (int ks = 0; ks < 2; ++ks) {
            u32x4 pw; pw.x = cvtpk(S[kt][8 * ks + 0], S[kt][8 * ks + 1]); pw.y = cvtpk(S[kt][8 * ks + 2], S[kt][8 * ks + 3]);
            pw.z = cvtpk(S[kt][8 * ks + 4], S[kt][8 * ks + 5]); pw.w = cvtpk(S[kt][8 * ks + 6], S[kt][8 * ks + 7]);
            const bf16x8 pb = __builtin_bit_cast(bf16x8, pw);
#pragma unroll
            for (int dt = 0; dt < 2; ++dt) {
                const LAS unsigned char* vp = Vt + (32 * dt + l31) * VPITCH + (32 * kt + 16 * ks + 4 * hi) * 2;
                const u32x2 v0 = *(const LAS u32x2*)vp, v1 = *(const LAS u32x2*)(vp + 16);
                u32x4 vv; vv.x = v0.x; vv.y = v0.y; vv.z = v1.x; vv.w = v1.y;
                O[dt] = __builtin_amdgcn_mfma_f32_32x32x16_bf16(__builtin_bit_cast(bf16x8, vv), pb, O[dt], 0, 0, 0);
            }
        }
    if (qvalid) {
#pragma unroll
        for (int dt = 0; dt < 2; ++dt)
#pragma unroll
            for (int r4 = 0; r4 < 4; ++r4) {
                u32x2 w; w.x = cvtpk(O[dt][4 * r4] * inv, O[dt][4 * r4 + 1] * inv); w.y = cvtpk(O[dt][4 * r4 + 2] * inv, O[dt][4 * r4 + 3] * inv);
                *(u32x2*)(optr + 32 * dt + 8 * r4 + 4 * hi) = w;
            }
    }
}

struct Args { const float* in[18]; float* out; unsigned char* ws; int ph_lo, ph_hi; };
enum { T_PRO = 0, T_FFIN, T_FFOUT, T_NORM, T_CIN, T_CV, T_COUT, T_KV, T_QG, T_ATT, T_WO, T_FINAL };
constexpr int NPH = 22;

__global__ void __launch_bounds__(NTHREADS, 2) mega_fwd(Args a) {
    extern __shared__ __attribute__((aligned(16))) unsigned char lds_raw[];
    LAS unsigned char* lds = (LAS unsigned char*)lds_raw;
    const int tid0 = threadIdx.x, wave = __builtin_amdgcn_readfirstlane(tid0 >> 6);
    const int G = gridDim.x, bid = blockIdx.x;
    const int gw = bid * NWAVES + wave, NGW = G * NWAVES;
    unsigned char* ws = a.ws; float* out = a.out;
    float* X = (float*)(ws + WS_X); bf16* H = (bf16*)(ws + WS_H); bf16* KB = (bf16*)(ws + WS_K); bf16* VB = (bf16*)(ws + WS_V);
    bf16* ACT = (bf16*)(ws + WS_ACT); bf16* BC = (bf16*)(ws + WS_BC); bf16* U = (bf16*)(ws + WS_U); bf16* Q = (bf16*)(ws + WS_Q); bf16* O = (bf16*)(ws + WS_O);
    const float* tab = (const float*)(ws + WS_TAB);

    for (int ph = a.ph_lo; ph < a.ph_hi; ++ph) {
        int type, arg = 0; bool sync_after = true;
        int tid = tid0; asm volatile("" : "+v"(tid));
        const int lane = tid & 63;
        switch (ph) {
            case 0: type = T_PRO; break;
            case 1: type = T_FFIN; arg = 0; break;   case 2: type = T_FFOUT; arg = 0; break;  case 3: type = T_NORM; break;
            case 4: type = T_CIN; break;             case 5: type = T_CV; break;              case 6: type = T_COUT; break;   case 7: type = T_NORM; break;
            case 8: type = T_FFIN; arg = 1; break;   case 9: type = T_FFOUT; arg = 1; break;  case 10: type = T_NORM; break;
            case 11: type = T_KV; sync_after = false; break;
            case 12: type = T_FFIN; arg = 2; break;  case 13: type = T_FFOUT; arg = 2; break; case 14: type = T_NORM; break;
            case 15: type = T_QG; break;             case 16: type = T_ATT; break;            case 17: type = T_WO; break;    case 18: type = T_NORM; break;
            case 19: type = T_FFIN; arg = 3; break;  case 20: type = T_FFOUT; arg = 3; break;
            default: type = T_FINAL; break;
        }

        if (EN(T_PRO) && type == T_PRO) {
            LAS float* scr = (LAS float*)(lds + wave * 16384);
            constexpr int I_FFIN = 16 * 176, I_FFOUT = 44 * 32, I_CIN = 16 * 96, I_SQ = 16 * 32, I_KV = 16 * 16;
            constexpr int NITEMS = 4 * I_FFIN + 4 * I_FFOUT + I_CIN + I_SQ + I_KV + I_SQ + I_SQ;
            for (int it = gw; it < NITEMS; it += NGW) {
                int r = it; const float* W; const float* g = nullptr; bf16* WT; int Nsrc, K, Ndst, map;
                if (r < 4 * I_FFIN) { const int wi = r / I_FFIN; r -= wi * I_FFIN; W = a.in[7] + (size_t)wi * D * 2 * FF; Nsrc = 2 * FF; K = D; Ndst = 2 * FF; map = 1;
                    g = a.in[6] + ((wi >> 1) * 3 + ((wi & 1) ? 2 : 0)) * D; WT = (bf16*)(ws + WS_FFIN + wi * SZ_FFIN); }
                else if ((r -= 4 * I_FFIN) < 4 * I_FFOUT) { const int wi = r / I_FFOUT; r -= wi * I_FFOUT; W = a.in[8] + (size_t)wi * FF * D; Nsrc = D; K = FF; Ndst = D; map = 0; WT = (bf16*)(ws + WS_FFOUT + wi * SZ_FFOUT); }
                else if ((r -= 4 * I_FFOUT) < I_CIN) { W = a.in[9]; Nsrc = 3 * D; K = D; Ndst = 3 * D; map = 2; g = a.in[6] + 1 * D; WT = (bf16*)(ws + WS_CIN); }
                else if ((r -= I_CIN) < I_SQ) { W = a.in[11]; Nsrc = D; K = D; Ndst = D; map = 0; WT = (bf16*)(ws + WS_COUT); }
                else if ((r -= I_SQ) < I_KV) { W = a.in[13]; Nsrc = 512; K = D; Ndst = 512; map = 3; g = a.in[12]; WT = (bf16*)(ws + WS_KVW); }
                else if ((r -= I_KV) < I_SQ) { W = a.in[14]; Nsrc = D; K = D; Ndst = D; map = 4; g = a.in[6] + 4 * D; WT = (bf16*)(ws + WS_QW); }
                else { r -= I_SQ; W = a.in[15]; Nsrc = D; K = D; Ndst = D; map = 0; WT = (bf16*)(ws + WS_OW); }
                const int nblk = Ndst / 32, kb = r / nblk, nb = r % nblk, n0 = nb * 32;
                int src;
                if (map == 1) src = ((n0 >> 7) & 1) * FF + (n0 >> 8) * 128 + (n0 & 127);
                else if (map == 2) src = n0 < 2048 ? D + ((n0 >> 7) & 1) * D + (n0 >> 8) * 128 + (n0 & 127) : n0 - 2048;
                else if (map == 3) src = n0 < 256 ? ((n0 & 127) >> 5) * 64 + (n0 >> 7) * 32 : n0;
                else if (map == 4) src = ((n0 >> 8) * 4 + ((n0 & 127) >> 5)) * 64 + ((n0 >> 7) & 1) * 32;
                else src = n0;
                wt_item(W, Nsrc, K, src, WT + (size_t)n0 * K, g, kb * 64, scr, lane);
            }
            for (int row = gw; row < MP; row += NGW) {
                const float* src = nullptr;
                if (row < NPR) { const int b = row >= LP ? 1 : 0, pos = row - b * LP; src = pos < 16 ? a.in[5] + (size_t)pos * D : a.in[0] + ((size_t)b * 8192 + pos - 16) * D; }
                else if (row < MR) src = a.in[1] + (size_t)(row - NPR) * D;
                norm_row(src, X + (size_t)row * D, H + (size_t)row * D, lane);
            }
            for (int i = bid * NTHREADS + tid; i < LP * 32; i += G * NTHREADS) {
                const int pos = i >> 5, dd = i & 31;
                const double rev = (double)pos * c_rope_inv[dd] * 0.15915494309189535;
                const float fr = (float)(rev - __builtin_rint(rev));
                ((float*)(ws + WS_TAB))[2 * i] = __builtin_amdgcn_cosf(fr); ((float*)(ws + WS_TAB))[2 * i + 1] = __builtin_amdgcn_sinf(fr);
            }
            for (int i = bid * NTHREADS + tid; i < 128 * 124 * 64; i += G * NTHREADS) {
                const int b = i / (124 * 64), r = i - b * (124 * 64);
                *((f32x4*)(out + OK_S + (size_t)b * 32768) + r) = *((const f32x4*)(a.in[3] + (size_t)b * 32768 + 1024) + r);
                *((f32x4*)(out + OV_S + (size_t)b * 32768) + r) = *((const f32x4*)(a.in[4] + (size_t)b * 32768 + 1024) + r);
            }
        } else if (EN(T_FFIN) && (type == T_FFIN || type == T_FFOUT || type == T_CIN || type == T_COUT || type == T_KV || type == T_QG || type == T_WO)) {
            pg8::Gemm g; pg8::EpiMulti E; g.M = MP; g.A = H; g.K = D; E.X = X; E.tab = tab; E.scale = 1.0f; E.perm = true; E.o0 = ACT; E.o1 = U;
            if (type == T_FFIN)       { g.Bt = (const bf16*)(ws + WS_FFIN + arg * SZ_FFIN); g.N = 2 * FF; E.kind = pg8::EK_SWIGLU; }
            else if (type == T_FFOUT) { g.A = ACT; g.Bt = (const bf16*)(ws + WS_FFOUT + arg * SZ_FFOUT); g.N = D; g.K = FF; E.kind = pg8::EK_RESID; E.perm = false; E.scale = 0.5f; }
            else if (type == T_CIN)   { g.Bt = (const bf16*)(ws + WS_CIN); g.N = 3 * D; E.kind = pg8::EK_CONVIN; E.o0 = BC; E.o1 = U; }
            else if (type == T_COUT)  { g.Bt = (const bf16*)(ws + WS_COUT); g.N = D; E.kind = pg8::EK_RESID; E.perm = false; }
            else if (type == T_KV)    { g.Bt = (const bf16*)(ws + WS_KVW); g.N = 512; E.kind = pg8::EK_KV; E.o0 = KB; E.o1 = VB; }
            else if (type == T_QG)    { g.Bt = (const bf16*)(ws + WS_QW); g.N = D; E.kind = pg8::EK_Q; E.o0 = Q; E.scale = QSCALE; }
            else                      { g.A = O; g.Bt = (const bf16*)(ws + WS_OW); g.N = D; E.kind = pg8::EK_RESID; E.perm = false; }
            pg8::StaticOrder S; S.init(MP, g.N, G, bid);
            pg8::gemm_phase<pg8::EpiMulti, pg8::StaticOrder, true, true>(lds, g, S, E);
        } else if (EN(T_NORM) && type == T_NORM) {
            for (int row = gw; row < MP; row += NGW) norm_row(X + (size_t)row * D, nullptr, H + (size_t)row * D, lane);
        } else if (EN(T_CV) && type == T_CV) {
            const float* ck = a.in[10]; const float* st = a.in[2];
            for (int row = gw; row < MR; row += NGW) {
                int t; const float* sp = nullptr;
                const long oo = conv_out_off(row);
                if (row < NPR) t = row < LP ? row : row - LP; else { const int r = row - NPR; t = r & 3; sp = st + (size_t)(r >> 2) * 2 * D; }
#pragma unroll
                for (int j = 0; j < 2; ++j) {
                    const int ch = j * 512 + lane * 8;
                    const u32x4 bw = *(const u32x4*)(BC + (size_t)row * D + ch), u2 = *(const u32x4*)(U + (size_t)row * D + ch);
                    float u0f[8], u1f[8];
                    if (t >= 2) { const u32x4 w = *(const u32x4*)(U + (size_t)(row - 2) * D + ch);
#pragma unroll
                        for (int e = 0; e < 4; ++e) { u0f[2 * e] = bf_lo(w[e]); u0f[2 * e + 1] = bf_hi(w[e]); } }
                    else if (sp) { const f32x4 p = *(const f32x4*)(sp + (size_t)t * D + ch), q = *(const f32x4*)(sp + (size_t)t * D + ch + 4);
#pragma unroll
                        for (int e = 0; e < 4; ++e) { u0f[e] = p[e]; u0f[4 + e] = q[e]; } }
                    else {
#pragma unroll
                        for (int e = 0; e < 8; ++e) u0f[e] = 0.f; }
                    if (t >= 1) { const u32x4 w = *(const u32x4*)(U + (size_t)(row - 1) * D + ch);
#pragma unroll
                        for (int e = 0; e < 4; ++e) { u1f[2 * e] = bf_lo(w[e]); u1f[2 * e + 1] = bf_hi(w[e]); } }
                    else if (sp) { const f32x4 p = *(const f32x4*)(sp + (size_t)(t + 1) * D + ch), q = *(const f32x4*)(sp + (size_t)(t + 1) * D + ch + 4);
#pragma unroll
                        for (int e = 0; e < 4; ++e) { u1f[e] = p[e]; u1f[4 + e] = q[e]; } }
                    else {
#pragma unroll
                        for (int e = 0; e < 8; ++e) u1f[e] = 0.f; }
                    float k0[8], k1[8], k2[8];
                    { const f32x4 p = *(const f32x4*)(ck + ch), q = *(const f32x4*)(ck + ch + 4), r = *(const f32x4*)(ck + D + ch), s = *(const f32x4*)(ck + D + ch + 4),
                                  v = *(const f32x4*)(ck + 2 * D + ch), w = *(const f32x4*)(ck + 2 * D + ch + 4);
#pragma unroll
                      for (int e = 0; e < 4; ++e) { k0[e] = p[e]; k0[4 + e] = q[e]; k1[e] = r[e]; k1[4 + e] = s[e]; k2[e] = v[e]; k2[4 + e] = w[e]; } }
                    float cv[8];
#pragma unroll
                    for (int e = 0; e < 4; ++e) {
                        const float bl = bf_lo(bw[e]), bh = bf_hi(bw[e]), ul = bf_lo(u2[e]), uh = bf_hi(u2[e]);
                        cv[2 * e] = bl * (k0[2 * e] * u0f[2 * e] + k1[2 * e] * u1f[2 * e] + k2[2 * e] * ul);
                        cv[2 * e + 1] = bh * (k0[2 * e + 1] * u0f[2 * e + 1] + k1[2 * e + 1] * u1f[2 * e + 1] + k2[2 * e + 1] * uh);
                    }
                    u32x4 o; o.x = cvtpk(cv[0], cv[1]); o.y = cvtpk(cv[2], cv[3]); o.z = cvtpk(cv[4], cv[5]); o.w = cvtpk(cv[6], cv[7]);
                    *(u32x4*)(H + (size_t)row * D + ch) = o;
                    if (oo >= 0) { *(f32x4*)(out + oo + ch) = (f32x4){bf_lo(u2[0]), bf_hi(u2[0]), bf_lo(u2[1]), bf_hi(u2[1])}; *(f32x4*)(out + oo + ch + 4) = (f32x4){bf_lo(u2[2]), bf_hi(u2[2]), bf_lo(u2[3]), bf_hi(u2[3])}; }
                }
            }
        } else if (EN(T_ATT) && type == T_ATT) {
            const LAS unsigned char* Ks = lds + ATT_KS; const LAS unsigned char* Vt = lds + ATT_VT;
            const float* sinks = a.in[16];
            constexpr int NPU = 2 * 4 * 129, NSU = 128 * 4;
            for (int i = bid * NTHREADS + tid; i < (256 + 512) * 32; i += G * NTHREADS) {
                const int rr = i >> 5, ch = (i & 31) * 8; int row;
                if (rr < 256) row = (rr >> 7) * LP + (LP - 128) + (rr & 127); else row = NPR + rr - 256;
                long vd; const long oo = kv_out_off(row, vd);
                const u32x4 kk = *(const u32x4*)(KB + (size_t)row * 256 + ch), vv = *(const u32x4*)(VB + (size_t)row * 256 + ch);
                *(f32x4*)(out + oo + ch) = (f32x4){bf_lo(kk[0]), bf_hi(kk[0]), bf_lo(kk[1]), bf_hi(kk[1])}; *(f32x4*)(out + oo + ch + 4) = (f32x4){bf_lo(kk[2]), bf_hi(kk[2]), bf_lo(kk[3]), bf_hi(kk[3])};
                *(f32x4*)(out + oo + vd + ch) = (f32x4){bf_lo(vv[0]), bf_hi(vv[0]), bf_lo(vv[1]), bf_hi(vv[1])}; *(f32x4*)(out + oo + vd + ch + 4) = (f32x4){bf_lo(vv[2]), bf_hi(vv[2]), bf_lo(vv[3]), bf_hi(vv[3])};
            }
            for (int u = bid; u < NPU + NSU; u += G) {
                __syncthreads();
                if (u < NPU) {
                    const int b = u / 516, rem = u - b * 516, kvh = rem / 129, qb = rem - kvh * 129, q0 = qb * 64;
                    for (int c = tid; c < 192 * 8; c += NTHREADS) {
                        const int key = c >> 3, chn = c & 7, pos = q0 - 128 + key;
                        u32x4 kk = {0u, 0u, 0u, 0u}, vv = {0u, 0u, 0u, 0u};
                        if (pos >= 0 && pos < LP) { const size_t off = (size_t)(b * LP + pos) * 256 + kvh * 64 + chn * 8; kk = *(const u32x4*)(KB + off); vv = *(const u32x4*)(VB + off); }
                        *(LAS u32x4*)(lds + ATT_KS + key * KPITCH + chn * 16) = kk;
#pragma unroll
                        for (int e = 0; e < 4; ++e) {
                            *(LAS unsigned short*)(lds + ATT_VT + (chn * 8 + 2 * e) * VPITCH + key * 2) = (unsigned short)(vv[e] & 0xffffu);
                            *(LAS unsigned short*)(lds + ATT_VT + (chn * 8 + 2 * e + 1) * VPITCH + key * 2) = (unsigned short)(vv[e] >> 16);
                        }
                    }
                    __syncthreads();
                    const int gq = wave & 3, half = wave >> 2, head = kvh * 4 + gq, qp = q0 + 32 * half + (lane & 31);
                    const bool qvalid = qp < LP; const size_t qoff = (size_t)(b * LP + qp) * D + head * 64;
                    attn_wave(Ks + 32 * half * KPITCH, Vt + 32 * half * 2, Q + qoff, O + qoff, qvalid, qp, q0 - 128 + 32 * half, sinks[head] * LOG2E, lane);
                } else {
                    const int su = u - NPU, bb = su >> 2, kvh = su & 3;
                    for (int c = tid; c < 160 * 8; c += NTHREADS) {
                        const int key = c >> 3, chn = c & 7;
                        u32x4 kk = {0u, 0u, 0u, 0u}, vv = {0u, 0u, 0u, 0u};
                        if (key < 128) {
                            const size_t off = ((size_t)(bb * 128 + key) * 4 + kvh) * 64 + chn * 8;
                            const f32x4 k0 = *(const f32x4*)(a.in[3] + off), k1 = *(const f32x4*)(a.in[3] + off + 4), v0 = *(const f32x4*)(a.in[4] + off), v1 = *(const f32x4*)(a.in[4] + off + 4);
                            kk.x = cvtpk(k0[0], k0[1]); kk.y = cvtpk(k0[2], k0[3]); kk.z = cvtpk(k1[0], k1[1]); kk.w = cvtpk(k1[2], k1[3]);
                            vv.x = cvtpk(v0[0], v0[1]); vv.y = cvtpk(v0[2], v0[3]); vv.z = cvtpk(v1[0], v1[1]); vv.w = cvtpk(v1[2], v1[3]);
                        } else if (key < 132) { const size_t off = (size_t)(NPR + bb * 4 + key - 128) * 256 + kvh * 64 + chn * 8; kk = *(const u32x4*)(KB + off); vv = *(const u32x4*)(VB + off); }
                        *(LAS u32x4*)(lds + ATT_KS + key * KPITCH + chn * 16) = kk;
#pragma unroll
                        for (int e = 0; e < 4; ++e) {
                            *(LAS unsigned short*)(lds + ATT_VT + (chn * 8 + 2 * e) * VPITCH + key * 2) = (unsigned short)(vv[e] & 0xffffu);
                            *(LAS unsigned short*)(lds + ATT_VT + (chn * 8 + 2 * e + 1) * VPITCH + key * 2) = (unsigned short)(vv[e] >> 16);
                        }
                    }
                    __syncthreads();
                    if (wave == 0) {
                        const int q = lane & 31, gq = (q >> 2) & 3, t = q & 3, head = kvh * 4 + gq;
                        const bool qvalid = q < 16; const size_t qoff = (size_t)(NPR + bb * 4 + t) * D + head * 64;
                        attn_wave(Ks, Vt, Q + qoff, O + qoff, qvalid, 8192 + t, 8064, sinks[head] * LOG2E, lane);
                    }
                }
            }
            __syncthreads();
        } else if (EN(T_FINAL)) {
            const float* fg = a.in[17];
            for (int row = gw; row < MR; row += NGW) {
                float* dst;
                if (row < NPR) { const int b = row >= LP ? 1 : 0, pos = row - b * LP; if (pos < 16) continue; dst = out + OY_P + ((size_t)b * 8192 + pos - 16) * D; }
                else dst = out + OY_S + (size_t)(row - NPR) * D;
                const float* xr = X + (size_t)row * D;
                f32x4 v[4]; float s = 0.f;
#pragma unroll
                for (int j = 0; j < 4; ++j) { v[j] = *((const f32x4*)xr + lane + 64 * j); s += (v[j][0] * v[j][0] + v[j][1] * v[j][1]) + (v[j][2] * v[j][2] + v[j][3] * v[j][3]); }
                const float rstd = 1.0f / sqrtf(wave_sum(s) * (1.0f / D) + 1e-6f);
#pragma unroll
                for (int j = 0; j < 4; ++j) { const f32x4 gg = *((const f32x4*)fg + lane + 64 * j); *((f32x4*)dst + lane + 64 * j) = v[j] * rstd * gg; }
            }
        }
        if (sync_after && ph + 1 < a.ph_hi) cg::this_grid().sync();
        else __syncthreads();
    }
}

extern "C" void kernel_launch(void* const* d_in, const int* in_sizes, int n_in, void* d_out, int out_size, void* d_ws, size_t ws_size, hipStream_t stream) {
    static int grid = 0;
    if (grid == 0) {
        if (n_in != 18 || out_size != (int)OUT_TOTAL || ws_size < WS_END) { fprintf(stderr, "kernel_launch: unexpected shapes (n_in %d, out %d, ws %zu, need %zu)\n", n_in, out_size, ws_size, (size_t)WS_END); grid = -1; return; }
        int dev = 0, cus = 0, per_cu = 0;
        (void)hipGetDevice(&dev); (void)hipDeviceGetAttribute(&cus, hipDeviceAttributeMultiprocessorCount, dev);
        if (hipFuncSetAttribute((const void*)mega_fwd, hipFuncAttributeMaxDynamicSharedMemorySize, LDS_BYTES) != hipSuccess) { fprintf(stderr, "kernel_launch: hipFuncSetAttribute failed\n"); grid = -1; return; }
        if (hipOccupancyMaxActiveBlocksPerMultiprocessor(&per_cu, (const void*)mega_fwd, NTHREADS, LDS_BYTES) != hipSuccess || per_cu < 1) { fprintf(stderr, "kernel_launch: occupancy query says %d\n", per_cu); per_cu = 1; }
        (void)hipGetLastError();
        grid = cus * 1;
        if (grid <= 0) grid = 256;
    }
    if (grid < 0) return;
    Args a{};
    for (int i = 0; i < 18; ++i) a.in[i] = (const float*)d_in[i];
    a.out = (float*)d_out; a.ws = (unsigned char*)d_ws;
#if ONE_LAUNCH
    a.ph_lo = 0; a.ph_hi = NPH;
    void* args[] = {&a};
    hipError_t e = hipLaunchCooperativeKernel((const void*)mega_fwd, dim3(grid), dim3(NTHREADS), args, LDS_BYTES, stream);
    if (e != hipSuccess) fprintf(stderr, "cooperative launch failed: %s (grid %d)\n", hipGetErrorString(e), grid);
#else
    for (int ph = 0; ph < NPH; ++ph) { a.ph_lo = ph; a.ph_hi = ph + 1; hipLaunchKernelGGL(mega_fwd, dim3(grid), dim3(NTHREADS), LDS_BYTES, stream, a); }
#endif
}
```
